# Optimizing an MI355X kernel written in HIP

```python
import jax, jax.numpy as jnp
from jax import lax
import numpy as np

D_MODEL = 1024
BATCH = 8
SEQ = 8192
DEPTH = 1

RWKV_HEAD = 64
RWKV_HEADS = D_MODEL // RWKV_HEAD
RWKV_WIDTH = RWKV_HEADS * RWKV_HEAD
DECAY_LORA = 64
ICLR_LORA = 64
GATE_LORA = 128
LNX_EPS = 64e-5
ATTN_HEAD = 64
ATTN_Q_HEADS = 16
ATTN_KV_HEADS = 2
ATTN_GROUP = ATTN_Q_HEADS // ATTN_KV_HEADS
ATTN_WIDTH = ATTN_Q_HEADS * ATTN_HEAD
KV_WIDTH = ATTN_KV_HEADS * ATTN_HEAD
WINDOW = 128
BLOCK = 128
ATTN_SCALE = ATTN_HEAD ** -0.5
NEG_INF = -1e30
N_KEYS = 128
N_EXPERTS = N_KEYS * N_KEYS
PEER_HEADS = 8
PEER_QDIM = 256
PEER_HALF = PEER_QDIM // 2
PEER_TOPK = 16
PEER_CHUNK = 128
NORM_EPS = 1e-6
N_ADA = 6
N_SHIFT = 3 * RWKV_WIDTH + DECAY_LORA + ICLR_LORA + GATE_LORA
SHIFT_SPLITS = (RWKV_WIDTH, 2 * RWKV_WIDTH, 3 * RWKV_WIDTH,
                3 * RWKV_WIDTH + DECAY_LORA, 3 * RWKV_WIDTH + DECAY_LORA + ICLR_LORA)
REST_SPLITS = (ATTN_WIDTH, ATTN_WIDTH + KV_WIDTH, ATTN_WIDTH + 2 * KV_WIDTH,
               ATTN_WIDTH + 2 * KV_WIDTH + D_MODEL)
IN_WIDTH = N_SHIFT + ATTN_WIDTH + 2 * KV_WIDTH + 2 * D_MODEL

kernel_name = 'rwkv7_swa_sink_peer_hybrid'


def rms_norm(x, w):
    xf = x.astype(jnp.float32)
    y = xf * lax.rsqrt(jnp.mean(xf * xf, axis=-1, keepdims=True) + NORM_EPS)
    return (y * w.astype(jnp.float32)).astype(x.dtype)


def token_shift(p):
    return jnp.pad(p, ((0, 0), (1, 0), (0, 0)))[:, :-1, :]


def rwkv7_recurrence(r, decay, k, v, a, b):
    bsz, _, n_h, n = r.shape
    xs = tuple(jnp.moveaxis(t.astype(jnp.float32), 1, 0) for t in (r, decay, k, v, a, b))

    def step(state, inp):
        r_t, w_t, k_t, v_t, a_t, b_t = inp
        sa = jnp.einsum('bhvk,bhk->bhv', state, a_t)
        state = (state * w_t[:, :, None, :] + sa[..., None] * b_t[:, :, None, :]
                 + v_t[..., None] * k_t[:, :, None, :])
        return state, jnp.einsum('bhvk,bhk->bhv', state, r_t)

    state0 = jnp.zeros((bsz, n_h, n, n), jnp.float32)
    _, ys = lax.scan(step, state0, xs)
    return jnp.moveaxis(ys, 0, 1)


def rwkv7_mixer(pr, pk, pv, pw, pa, pg, w0, w_up, a0, a_up, g_up, k_k, k_a, r_k, lnx_w, lnx_b):
    bsz, seq, _ = pr.shape
    f32 = jnp.float32
    heads = lambda t: t.reshape(bsz, seq, RWKV_HEADS, RWKV_HEAD)
    w_log = -jax.nn.softplus(-(w0 + jnp.tanh(pw) @ w_up).astype(f32)) - 0.5
    decay = jnp.exp(-jnp.exp(w_log))
    a = jax.nn.sigmoid((a0 + pa @ a_up).astype(f32))
    g = jax.nn.sigmoid(pg) @ g_up
    kk = heads((pk * k_k).astype(f32))
    kk = kk / jnp.maximum(jnp.sqrt(jnp.sum(kk * kk, axis=-1, keepdims=True)), 1e-12)
    k = pk.astype(f32) * (1.0 + (a - 1.0) * k_a)
    r_h, k_h, v_h, a_h = heads(pr.astype(f32)), heads(k), heads(pv.astype(f32)), heads(a)
    y = rwkv7_recurrence(r_h, heads(decay), k_h, v_h, -kk, kk * a_h)
    mu = jnp.mean(y, axis=-1, keepdims=True)
    var = jnp.mean(jnp.square(y - mu), axis=-1, keepdims=True)
    y = ((y - mu) * lax.rsqrt(var + LNX_EPS)).reshape(bsz, seq, RWKV_WIDTH) * lnx_w + lnx_b
    bonus = jnp.sum(r_h * k_h * r_k, axis=-1, keepdims=True) * v_h
    y = (y + bonus.reshape(bsz, seq, RWKV_WIDTH)) * g
    return y.astype(pr.dtype)


def swa_sink_attention(q, k, v, q_norm_w, k_norm_w, sinks):
    bsz, seq, _ = q.shape
    nb = seq // BLOCK
    f32 = jnp.float32
    q = rms_norm(q.reshape(bsz, seq, ATTN_Q_HEADS, ATTN_HEAD), q_norm_w)
    k = rms_norm(k.reshape(bsz, seq, ATTN_KV_HEADS, ATTN_HEAD), k_norm_w)
    v = v.reshape(bsz, seq, ATTN_KV_HEADS, ATTN_HEAD)
    qb = q.reshape(bsz, nb, BLOCK, ATTN_KV_HEADS, ATTN_GROUP, ATTN_HEAD)

    def band(t):
        tb = t.reshape(bsz, nb, BLOCK, ATTN_KV_HEADS, ATTN_HEAD)
        prev = jnp.pad(tb, ((0, 0), (1, 0), (0, 0), (0, 0), (0, 0)))[:, :-1]
        return jnp.concatenate([prev, tb], axis=2)

    kb, vb = band(k), band(v)
    sink = sinks.astype(f32).reshape(ATTN_KV_HEADS, ATTN_GROUP)[None, :, :, None]
    qi = jnp.arange(BLOCK)[:, None]
    kj = jnp.arange(2 * BLOCK)[None, :]
    rel = kj - qi
    in_window = (rel >= BLOCK - WINDOW + 1) & (rel <= BLOCK)

    def one_block(args):
        q_blk, k_blk, v_blk, blk = args
        s = jnp.einsum('bqgnd,bkgd->bgnqk', q_blk, k_blk, preferred_element_type=f32) * ATTN_SCALE
        valid = in_window & (blk * BLOCK - BLOCK + kj >= 0)
        s = jnp.where(valid, s, NEG_INF)
        m = jnp.maximum(jnp.max(s, axis=-1), sink)
        p = jnp.exp(s - m[..., None])
        denom = jnp.sum(p, axis=-1) + jnp.exp(sink - m)
        p = p / denom[..., None]
        return jnp.einsum('bgnqk,bkgd->bqgnd', p.astype(v_blk.dtype), v_blk)

    out = lax.map(one_block, (jnp.moveaxis(qb, 1, 0), jnp.moveaxis(kb, 1, 0),
                              jnp.moveaxis(vb, 1, 0), jnp.arange(nb)))
    return jnp.moveaxis(out, 0, 1).reshape(bsz, seq, ATTN_WIDTH)


def peer_ffn(h, w_q, keys_1, keys_2, u_tab, v_tab):
    bsz, seq, d = h.shape
    chunks = h.reshape(bsz * seq // PEER_CHUNK, PEER_CHUNK, d)

    def one_chunk(xc):
        q = (xc @ w_q).reshape(PEER_CHUNK, PEER_HEADS, 2, PEER_HALF)
        s1 = jnp.einsum('chd,nd->chn', q[:, :, 0], keys_1)
        s2 = jnp.einsum('chd,nd->chn', q[:, :, 1], keys_2)
        v1, i1 = lax.top_k(s1, PEER_TOPK)
        v2, i2 = lax.top_k(s2, PEER_TOPK)
        cand = (v1[..., :, None] + v2[..., None, :]).reshape(PEER_CHUNK, PEER_HEADS, PEER_TOPK * PEER_TOPK)
        cidx = (i1[..., :, None] * N_KEYS + i2[..., None, :]).reshape(PEER_CHUNK, PEER_HEADS, PEER_TOPK * PEER_TOPK)
        sc, pos = lax.top_k(cand, PEER_TOPK)
        idx = jnp.take_along_axis(cidx, pos, axis=-1)
        gate = jax.nn.softmax(sc.astype(jnp.float32), axis=-1)
        u = jnp.take(u_tab, idx, axis=0)
        act = jax.nn.gelu(jnp.einsum('chkd,cd->chk', u, xc).astype(jnp.float32), approximate=False)
        wts = (gate * act).astype(xc.dtype)
        return jnp.einsum('chk,chkd->cd', wts, jnp.take(v_tab, idx, axis=0))

    return lax.map(one_chunk, chunks).reshape(bsz, seq, d)


def setup_inputs(seed: int = 0) -> dict:
    key = jax.random.key(seed)
    ks = jax.random.split(key, 27)
    f32 = jnp.float32
    nrm = lambda k, shape, s: jax.random.normal(k, shape, f32) * s
    L = DEPTH
    return {
        'x': nrm(ks[0], (BATCH, SEQ, D_MODEL), 1.0),
        'c': nrm(ks[1], (BATCH, D_MODEL), 1.0),
        'ada_w': nrm(ks[2], (L, D_MODEL, N_ADA * D_MODEL), 0.5 * D_MODEL ** -0.5),
        'ada_b': nrm(ks[3], (L, N_ADA * D_MODEL), 0.02),
        'norm1_w': 1.0 + nrm(ks[4], (L, D_MODEL), 0.05),
        'norm2_w': 1.0 + nrm(ks[5], (L, D_MODEL), 0.05),
        'w_in': nrm(ks[6], (L, D_MODEL, IN_WIDTH), D_MODEL ** -0.5),
        'shift_mu': jax.random.uniform(ks[7], (L, N_SHIFT), f32),
        'w0': jax.random.uniform(ks[8], (L, RWKV_WIDTH), f32, -5.0, 1.0),
        'w_lora_up': nrm(ks[9], (L, DECAY_LORA, RWKV_WIDTH), DECAY_LORA ** -0.5),
        'a0': nrm(ks[10], (L, RWKV_WIDTH), 0.5),
        'a_lora_up': nrm(ks[11], (L, ICLR_LORA, RWKV_WIDTH), ICLR_LORA ** -0.5),
        'g_lora_up': nrm(ks[12], (L, GATE_LORA, RWKV_WIDTH), GATE_LORA ** -0.5),
        'k_k': 0.85 + nrm(ks[13], (L, RWKV_WIDTH), 0.1),
        'k_a': 1.0 + nrm(ks[14], (L, RWKV_WIDTH), 0.1),
        'r_k': nrm(ks[15], (L, RWKV_HEADS, RWKV_HEAD), 0.1),
        'lnx_w': 1.0 + nrm(ks[16], (L, RWKV_WIDTH), 0.05),
        'lnx_b': nrm(ks[17], (L, RWKV_WIDTH), 0.02),
        'q_norm_w': 1.0 + nrm(ks[18], (L, ATTN_HEAD), 0.05),
        'k_norm_w': 1.0 + nrm(ks[19], (L, ATTN_HEAD), 0.05),
        'sinks': nrm(ks[20], (L, ATTN_Q_HEADS), 0.5),
        'w_out': nrm(ks[21], (L, D_MODEL, D_MODEL), D_MODEL ** -0.5),
        'peer_w_q': nrm(ks[22], (L, D_MODEL, PEER_HEADS * PEER_QDIM), D_MODEL ** -0.5),
        'peer_keys_1': nrm(ks[23], (L, N_KEYS, PEER_HALF), PEER_HALF ** -0.5),
        'peer_keys_2': nrm(ks[24], (L, N_KEYS, PEER_HALF), PEER_HALF ** -0.5),
        'peer_u': nrm(ks[25], (L, N_EXPERTS, D_MODEL), D_MODEL ** -0.5),
        'peer_v': nrm(ks[26], (L, N_EXPERTS, D_MODEL), PEER_HEADS ** -0.5),
    }


def reference(x, c, ada_w, ada_b, norm1_w, norm2_w, w_in, shift_mu, w0, w_lora_up, a0,
              a_lora_up, g_lora_up, k_k, k_a, r_k, lnx_w, lnx_b, q_norm_w, k_norm_w, sinks,
              w_out, peer_w_q, peer_keys_1, peer_keys_2, peer_u, peer_v):
    cond = jax.nn.silu(c)
    for l in range(DEPTH):
        ada = cond @ ada_w[l] + ada_b[l]
        sh1, sc1, gt1, sh2, sc2, gt2 = [t[:, None, :] for t in jnp.split(ada, N_ADA, axis=-1)]

        h = rms_norm(x, norm1_w[l]) * (1.0 + sc1) + sh1
        proj = h @ w_in[l]
        shifted, rest = proj[..., :N_SHIFT], proj[..., N_SHIFT:]
        shifted = shifted + (token_shift(shifted) - shifted) * shift_mu[l]
        pr, pk, pv, pw, pa, pg = jnp.split(shifted, SHIFT_SPLITS, axis=-1)
        aq, ak, av, gate_a, gate_b = jnp.split(rest, REST_SPLITS, axis=-1)
        y_a = rwkv7_mixer(pr, pk, pv, pw, pa, pg, w0[l], w_lora_up[l], a0[l], a_lora_up[l],
                          g_lora_up[l], k_k[l], k_a[l], r_k[l], lnx_w[l], lnx_b[l])
        y_b = swa_sink_attention(aq, ak, av, q_norm_w[l], k_norm_w[l], sinks[l])
        mixed = jax.nn.sigmoid(gate_a) * y_a + jax.nn.sigmoid(gate_b) * y_b
        x = x + gt1 * (mixed @ w_out[l])

        h2 = rms_norm(x, norm2_w[l]) * (1.0 + sc2) + sh2
        x = x + gt2 * peer_ffn(h2, peer_w_q[l], peer_keys_1[l], peer_keys_2[l], peer_u[l], peer_v[l])
    return x
```

```cpp
#include <hip/hip_runtime.h>
#include <cstdio>
#include <cstdint>
#include <cmath>
#ifndef MK_N_LAUNCHES
#define MK_N_LAUNCHES 11
#endif
namespace pg8 {
#define PG8_LAS __attribute__((address_space(3)))
typedef unsigned short bf16_t;
typedef short bf16x8 __attribute__((ext_vector_type(8)));
typedef float f32x4 __attribute__((ext_vector_type(4)));
typedef unsigned u32x4 __attribute__((ext_vector_type(4)));
constexpr int BM = 256, BK = 64, HALF = 128, HTB = HALF * BK * 2  , STAGE_BYTES = 8 * HTB, NXCD = 8, WGM = 8;

__host__ __device__ __forceinline__ int lds_byte(int r, int c) { const int st = (r >> 4) * 2 + (c >> 5), rr = r & 15, cc = c & 31, ob = rr * 64 + cc * 2; return st * 1024 + (ob ^ (((ob >> 9) & 1) << 5)); }
__host__ __device__ __forceinline__ void stage_rc(int b, int& R, int& C) { const int st = b / 1024, sb = b % 1024, swz = sb ^ (((sb >> 9) & 1) << 5); R = (st >> 1) * 16 + swz / 64; C = (st & 1) * 32 + (swz % 64) / 2; }
__host__ __device__ __forceinline__ int perm32(int rho) { const int n = rho >> 4, i = rho & 15; return 8 * (i >> 2) + 4 * n + (i & 3); }

struct Unit { int pm, pn; };
struct Gemm { const bf16_t* A; const bf16_t* Bt; int M, N, K; };

struct StaticOrder {
    int nM, nN, nwg, G, c;
    __host__ __device__ void init(int M, int N, int G_, int c_) { nM = M / BM; nN = N / BM; nwg = nM * nN; G = G_; c = c_; }
    __host__ __device__ bool next(int i, Unit& u) const {
        const long L = (long)i * G + c; if (L >= nwg) return false;
        int wgid = (int)L; { const int q = nwg / NXCD, r = nwg % NXCD, xcd = wgid % NXCD, off = wgid / NXCD; wgid = (xcd < r ? xcd * (q + 1) : r * (q + 1) + (xcd - r) * q) + off; }
        const int nig = WGM * nN, gid = wgid / nig, fm = gid * WGM, gsz = (nM - fm) < WGM ? (nM - fm) : WGM;
        u.pm = fm + ((wgid % nig) % gsz); u.pn = (wgid % nig) / gsz; return true;
    }
    __device__ __forceinline__ void a_ready(const Unit&) const {}
    __device__ __forceinline__ void done(const Unit&) const {}
};

__device__ __forceinline__ unsigned cvt_pk_bf16(float lo, float hi) { unsigned r; asm volatile("v_cvt_pk_bf16_f32 %0, %1, %2" : "=v"(r) : "v"(lo), "v"(hi)); return r; }
typedef float f32x2 __attribute__((ext_vector_type(2)));
__device__ __forceinline__ f32x2 gelu_pk(f32x2 v) {
    const f32x2 av = __builtin_elementwise_abs(v), d = av * 0.2316418882f + 1.0f;
    f32x2 t; t.x = __builtin_amdgcn_rcpf(d.x); t.y = __builtin_amdgcn_rcpf(d.y);
    f32x2 q = t * 0.5307027145f + (-0.7265760135f); q = q * t + 0.7107068705f; q = q * t + (-0.142248368f); q = q * t + 0.127414796f; q = q * t;
    const f32x2 s = (v * v) * (-0.72134752044f);
    f32x2 e; e.x = __builtin_amdgcn_exp2f(s.x); e.y = __builtin_amdgcn_exp2f(s.y);
    const f32x2 m = v * (q * e), r = v - m;
    f32x2 o; o.x = v.x < 0.f ? m.x : r.x; o.y = v.y < 0.f ? m.y : r.y; return o;
}

template <int ACT  > struct EpiBf16 {
    static constexpr bool PERM = true, AFTER_DRAIN = false; static_assert(ACT == 0 || ACT == 1, "EpiBf16: ACT is 0 (none) or 1 (gelu_pk)");
    bf16_t* O; int ldc; const float* bias; int split_cols; size_t split_stride; float scale0;
    __device__ __forceinline__ void operator()(const f32x4 (&acc)[2][2][4][2], const Unit& u, int wr, int wc, int fr, int fq) const {
        const int row0 = u.pm * BM + wr * 64 + fr; int colt = u.pn * BM; bf16_t* base = O;
        float sc = 1.f; if (split_cols) { const int t = colt / split_cols; base += (size_t)t * split_stride; colt -= t * split_cols; if (t == 0) sc = scale0; }
        const int col0 = colt + wc * 32 + 8 * fq, bcol0 = u.pn * BM + wc * 32 + 8 * fq;
        f32x4 bv[2][2];
#pragma unroll
        for (int bj = 0; bj < 2; ++bj)
#pragma unroll
            for (int n = 0; n < 2; ++n) bv[bj][n] = bias ? *(const f32x4*)(bias + bcol0 + bj * HALF + 4 * n) : (f32x4){0.f, 0.f, 0.f, 0.f};
#pragma unroll
        for (int ai = 0; ai < 2; ++ai)
#pragma unroll
            for (int m = 0; m < 4; ++m) { bf16_t* rowp = base + (size_t)(row0 + ai * HALF + m * 16) * ldc + col0;
#pragma unroll
                for (int bj = 0; bj < 2; ++bj) { f32x4 v0 = acc[ai][bj][m][0] + bv[bj][0], v1 = acc[ai][bj][m][1] + bv[bj][1];
                    if (ACT == 1) { f32x2 a = gelu_pk((f32x2){v0[0], v0[1]}), b = gelu_pk((f32x2){v0[2], v0[3]}), c = gelu_pk((f32x2){v1[0], v1[1]}), d = gelu_pk((f32x2){v1[2], v1[3]});
                        v0 = (f32x4){a.x, a.y, b.x, b.y}; v1 = (f32x4){c.x, c.y, d.x, d.y}; }
                    v0 = v0 * sc; v1 = v1 * sc; u32x4 w; w.x = cvt_pk_bf16(v0[0], v0[1]); w.y = cvt_pk_bf16(v0[2], v0[3]); w.z = cvt_pk_bf16(v1[0], v1[1]); w.w = cvt_pk_bf16(v1[2], v1[3]);
                    *(u32x4*)(rowp + bj * HALF) = w; } }
    }
};
struct EpiResid {
    static constexpr bool PERM = false, AFTER_DRAIN = false;
    const float* xin; float* out; const float* gt;
    __device__ __forceinline__ void operator()(const f32x4 (&acc)[2][2][4][2], const Unit& u, int wr, int wc, int fr, int fq) const {
        const int b = u.pm >> 5; const float* g = gt + b * 6144;
        const int col0 = u.pn * BM + wc * 32 + 4 * fq;
        f32x4 gv[2][2];
#pragma unroll
        for (int bj = 0; bj < 2; ++bj)
#pragma unroll
            for (int n = 0; n < 2; ++n) gv[bj][n] = *(const f32x4*)(g + col0 + bj * HALF + n * 16);
#pragma unroll
        for (int ai = 0; ai < 2; ++ai)
#pragma unroll
            for (int m = 0; m < 4; ++m) { const size_t off = (size_t)(u.pm * BM + ai * HALF + wr * 64 + m * 16 + fr) * 1024 + col0;
#pragma unroll
                for (int bj = 0; bj < 2; ++bj)
#pragma unroll
                    for (int n = 0; n < 2; ++n) { const f32x4 xv = *(const f32x4*)(xin + off + bj * HALF + n * 16);
                        *(f32x4*)(out + off + bj * HALF + n * 16) = xv + gv[bj][n] * acc[ai][bj][m][n]; } }
    }
};
template <class Epi, class Sched, bool ALIGN_EPI = false, bool SP2 = false>
__device__ __forceinline__ void gemm_phase(PG8_LAS unsigned char* lds, const Gemm g, const Sched& S, const Epi& E) {
    const int tid = threadIdx.x, wid = __builtin_amdgcn_readfirstlane(tid >> 6), lane = tid & 63, wr = wid >> 2, wc = wid & 3, fr = lane & 15, fq = lane >> 4;
    const int K = g.K, nt = K / BK;
    unsigned voffA[2], voffB[2];
#pragma unroll
    for (int i = 0; i < 2; ++i) { int R, C; stage_rc(tid * 16 + i * 8192, R, C); const int Rb = Epi::PERM ? ((R & ~31) + perm32(R & 31)) : R;
        voffA[i] = (unsigned)(R * K + C) * 2u; voffB[i] = (unsigned)(Rb * K + C) * 2u; }
    const size_t kstep = (size_t)(BK * 2);
    const size_t hstep = (size_t)HALF * K * 2;
    const size_t tstep = 2 * hstep;
    const unsigned ldsw = (unsigned)wid * 1024u;
    const int aoff = lds_byte(wr * 64 + fr, fq * 8), boff = lds_byte(wc * 32 + fr, fq * 8);
#define PG8_SA(b, h) (((b) * 2 + (h)) * HTB)
#define PG8_SB(b, h) ((4 + (b) * 2 + (h)) * HTB)
#define PG8_STAGE(bufoff, gbase, voff) do { _Pragma("unroll") for (int _i = 0; _i < 2; ++_i) \
        __builtin_amdgcn_global_load_lds((const unsigned*)((const char*)(gbase) + (voff)[_i]), (PG8_LAS unsigned*)(lds + (bufoff) + ldsw + _i * 8192), 16, 0, 0); } while (0)
#define PG8_LDA(dst, b, h) do { _Pragma("unroll") for (int m = 0; m < 4; ++m) _Pragma("unroll") for (int k = 0; k < 2; ++k) dst[m][k] = *(const PG8_LAS bf16x8*)(lds + PG8_SA(b, h) + aoff + m * 2048 + k * 1024); } while (0)
#define PG8_LDB(dst, b, h) do { _Pragma("unroll") for (int n = 0; n < 2; ++n) _Pragma("unroll") for (int k = 0; k < 2; ++k) dst[n][k] = *(const PG8_LAS bf16x8*)(lds + PG8_SB(b, h) + boff + n * 2048 + k * 1024); } while (0)
#define PG8_MMA(ai, bj, At, Bt) do { __builtin_amdgcn_s_setprio(1); _Pragma("unroll") for (int m = 0; m < 4; ++m) _Pragma("unroll") for (int n = 0; n < 2; ++n) _Pragma("unroll") for (int k = 0; k < 2; ++k) \
        acc[ai][bj][m][n] = __builtin_amdgcn_mfma_f32_16x16x32_bf16(Bt[n][k], At[m][k], acc[ai][bj][m][n], 0, 0, 0); __builtin_amdgcn_s_setprio(0); } while (0)
#define PG8_WAIT_V(n) asm volatile("s_waitcnt vmcnt(" #n ")" ::: "memory")
#define PG8_WAIT_L(n) asm volatile("s_waitcnt lgkmcnt(" #n ")" ::: "memory")
#define PG8_BAR __builtin_amdgcn_s_barrier()
#define PG8_SCHED __builtin_amdgcn_sched_barrier(0)
    Unit cur, nxt; int ui = 0;
    if (!S.next(0, cur)) return;
    f32x4 acc[2][2][4][2];
#pragma unroll
    for (int a = 0; a < 2; ++a)
#pragma unroll
        for (int b = 0; b < 2; ++b)
#pragma unroll
            for (int m = 0; m < 4; ++m)
#pragma unroll
                for (int n = 0; n < 2; ++n) acc[a][b][m][n] = (f32x4){0.f, 0.f, 0.f, 0.f};
    bf16x8 At[4][2], B0[2][2], B1[2][2];
    const char* cA = (const char*)g.A + (size_t)cur.pm * tstep; const char* cB = (const char*)g.Bt + (size_t)cur.pn * tstep;
    S.a_ready(cur);
    if constexpr (SP2) {
        PG8_STAGE(PG8_SB(0, 0), cB, voffB); PG8_STAGE(PG8_SB(0, 1), cB + hstep, voffB); PG8_STAGE(PG8_SA(0, 0), cA, voffA); PG8_STAGE(PG8_SA(0, 1), cA + hstep, voffA);
        if (wr == 1) PG8_BAR;
        PG8_WAIT_V(2); PG8_BAR;
        PG8_STAGE(PG8_SB(1, 0), cB + kstep, voffB); PG8_STAGE(PG8_SA(1, 0), cA + kstep, voffA); PG8_STAGE(PG8_SB(1, 1), cB + hstep + kstep, voffB);
        PG8_WAIT_V(6); PG8_BAR;
    } else {
        PG8_STAGE(PG8_SB(0, 0), cB, voffB); PG8_STAGE(PG8_SA(0, 0), cA, voffA); PG8_STAGE(PG8_SB(0, 1), cB + hstep, voffB); PG8_STAGE(PG8_SA(0, 1), cA + hstep, voffA);
        if (wr == 1) PG8_BAR;
        PG8_WAIT_V(4); PG8_BAR;
        PG8_STAGE(PG8_SB(1, 0), cB + kstep, voffB); PG8_STAGE(PG8_SA(1, 0), cA + kstep, voffA); PG8_STAGE(PG8_SB(1, 1), cB + hstep + kstep, voffB);
        PG8_WAIT_V(6); PG8_BAR;
    }
    for (;;) {
        const bool has_next = S.next(ui + 1, nxt);
        const char* nA = has_next ? (const char*)g.A + (size_t)nxt.pm * tstep : cA; const char* nB = has_next ? (const char*)g.Bt + (size_t)nxt.pn * tstep : cB;
        for (int t = 0; t < nt; t += 2) {
            const bool last = (t == nt - 2);
            const char* a1 = cA + (size_t)(t + 1) * kstep;
            const char* a2 = last ? nA : cA + (size_t)(t + 2) * kstep; const char* b2 = last ? nB : cB + (size_t)(t + 2) * kstep;
            const char* a3 = a2 + kstep; const char* b3 = b2 + kstep;
            if (last && has_next) S.a_ready(nxt);
            if constexpr (SP2) {
            PG8_LDB(B0, 0, 0); PG8_LDB(B1, 0, 1); PG8_SCHED; PG8_LDA(At, 0, 0); PG8_STAGE(PG8_SA(1, 1), a1 + hstep, voffA);
            PG8_WAIT_V(8); PG8_WAIT_L(0); PG8_BAR; PG8_MMA(0, 0, At, B0); PG8_MMA(0, 1, At, B1); PG8_BAR; PG8_SCHED;
            PG8_LDA(At, 0, 1); PG8_STAGE(PG8_SB(0, 0), b2, voffB); PG8_STAGE(PG8_SB(0, 1), b2 + hstep, voffB); PG8_STAGE(PG8_SA(0, 0), a2, voffA);
            PG8_WAIT_V(8); PG8_WAIT_L(0); PG8_BAR; PG8_MMA(1, 0, At, B0); PG8_MMA(1, 1, At, B1); PG8_BAR; PG8_SCHED;
            PG8_LDB(B0, 1, 0); PG8_LDB(B1, 1, 1); PG8_SCHED; PG8_LDA(At, 1, 0); PG8_STAGE(PG8_SA(0, 1), a2 + hstep, voffA);
            PG8_WAIT_V(8); PG8_WAIT_L(0); PG8_BAR; PG8_MMA(0, 0, At, B0); PG8_MMA(0, 1, At, B1); PG8_BAR; PG8_SCHED;
            PG8_LDA(At, 1, 1); PG8_STAGE(PG8_SB(1, 0), b3, voffB); PG8_STAGE(PG8_SB(1, 1), b3 + hstep, voffB); PG8_STAGE(PG8_SA(1, 0), a3, voffA);
            PG8_WAIT_V(8); PG8_WAIT_L(0); PG8_BAR; PG8_MMA(1, 0, At, B0); PG8_MMA(1, 1, At, B1); PG8_BAR; PG8_SCHED;
            } else {
            PG8_LDB(B0, 0, 0); PG8_SCHED; PG8_LDA(At, 0, 0); PG8_STAGE(PG8_SA(1, 1), a1 + hstep, voffA);
            PG8_WAIT_L(8); PG8_BAR; PG8_WAIT_L(0); PG8_MMA(0, 0, At, B0); PG8_BAR; PG8_SCHED;
            PG8_LDB(B1, 0, 1); PG8_STAGE(PG8_SB(0, 0), b2, voffB);
            PG8_BAR; PG8_WAIT_L(0); PG8_MMA(0, 1, At, B1); PG8_BAR;
            PG8_LDA(At, 0, 1); PG8_STAGE(PG8_SA(0, 0), a2, voffA);
            PG8_BAR; PG8_WAIT_L(0); PG8_MMA(1, 0, At, B0); PG8_BAR; PG8_SCHED;
            PG8_STAGE(PG8_SB(0, 1), b2 + hstep, voffB);
            PG8_WAIT_V(6); PG8_BAR; PG8_MMA(1, 1, At, B1); PG8_BAR;
            PG8_LDB(B0, 1, 0); PG8_SCHED; PG8_LDA(At, 1, 0); PG8_STAGE(PG8_SA(0, 1), a2 + hstep, voffA);
            PG8_WAIT_L(8); PG8_BAR; PG8_WAIT_L(0); PG8_MMA(0, 0, At, B0); PG8_BAR; PG8_SCHED;
            PG8_LDB(B1, 1, 1); PG8_STAGE(PG8_SB(1, 0), b3, voffB);
            PG8_BAR; PG8_WAIT_L(0); PG8_MMA(0, 1, At, B1); PG8_BAR;
            PG8_LDA(At, 1, 1); PG8_STAGE(PG8_SA(1, 0), a3, voffA);
            PG8_BAR; PG8_WAIT_L(0); PG8_MMA(1, 0, At, B0); PG8_BAR; PG8_SCHED;
            PG8_STAGE(PG8_SB(1, 1), b3 + hstep, voffB);
            PG8_WAIT_V(6); PG8_BAR; PG8_MMA(1, 1, At, B1); PG8_BAR;
            }
        }
        if constexpr (ALIGN_EPI) { if (wr == 0) PG8_BAR; }
        if constexpr (!Epi::AFTER_DRAIN) { E(acc, cur, wr, wc, fr, fq); S.done(cur); }
        if (!has_next) break;
#pragma unroll
        for (int a = 0; a < 2; ++a)
#pragma unroll
            for (int b = 0; b < 2; ++b)
#pragma unroll
                for (int m = 0; m < 4; ++m)
#pragma unroll
                    for (int n = 0; n < 2; ++n) acc[a][b][m][n] = (f32x4){0.f, 0.f, 0.f, 0.f};
        cur = nxt; cA = nA; cB = nB; ++ui;
        if constexpr (ALIGN_EPI) { if (wr == 1) PG8_BAR; }
    }
    PG8_WAIT_V(0);
    if constexpr (!ALIGN_EPI) { if (wr == 0) PG8_BAR; }
    PG8_BAR;
    if constexpr (Epi::AFTER_DRAIN) { E.fused(acc, cur, wr, wc, fr, fq, lds, wid, lane); S.done(cur); }
#undef PG8_SA
#undef PG8_SB
#undef PG8_STAGE
#undef PG8_LDA
#undef PG8_LDB
#undef PG8_MMA
#undef PG8_WAIT_V
#undef PG8_WAIT_L
#undef PG8_BAR
#undef PG8_SCHED
}
}

#ifndef PG8_SP2
#define PG8_SP2 true
#endif
#ifndef PG8_ALIGN
#define PG8_ALIGN true
#endif
constexpr int NWAVES = 8;
#ifndef MK_N_LAUNCHES
#define MK_N_LAUNCHES 1
#endif
constexpr int NPHASE = 11;
constexpr int BATCH = 8, SEQ = 8192, D = 1024, M = BATCH * SEQ;
constexpr int INW = 6656, NSHIFT = 3328;
constexpr int C_PR = 0, C_PK = 1024, C_PV = 2048, C_PW = 3072, C_PA = 3136, C_PG = 3200, C_AQ = 3328, C_AK = 4352, C_AV = 4480, C_GA = 4608, C_GB = 5632;
constexpr int NADA = 6144;
constexpr int NEXP = 16384;
constexpr size_t MiB = 1u << 20;
constexpr size_t WS_CTL = 0, CTL_ZERO_BYTES = 1 * MiB;
constexpr size_t WS_ADAP = 1 * MiB;
constexpr size_t WS_ADA = 4 * MiB;
constexpr size_t WS_WIN = 5 * MiB;
constexpr size_t WS_WOUT = 18 * MiB;
constexpr size_t WS_WQ = 22 * MiB;
constexpr size_t WS_WUP = 26 * MiB;
constexpr size_t WS_AUP = 26 * MiB + 128 * 1024;
constexpr size_t WS_GUP = 26 * MiB + 256 * 1024;
constexpr size_t WS_KEY1 = 27 * MiB, WS_KEY2 = 27 * MiB + 32 * 1024;
constexpr size_t WS_U = 28 * MiB, WS_V = 60 * MiB;
constexpr size_t WS_ACT = 92 * MiB;
constexpr size_t WS_P = 128 * MiB;
constexpr size_t WS_X1 = 128 * MiB;
constexpr size_t WS_H2 = 384 * MiB;
constexpr size_t WS_Q = 512 * MiB;
constexpr size_t WS_IDX = 768 * MiB;
constexpr size_t WS_GATE = 800 * MiB;
constexpr size_t WS_END = 960 * MiB;
constexpr int CW_BAR = 4096;
constexpr int RING_BYTES = 163840 - 1024;
constexpr int LDSCTL_OFF = RING_BYTES, MISC_OFF = LDSCTL_OFF + 320;
constexpr int LDS_BYTES = 163840;
#define GAS __attribute__((address_space(1)))
#define LAS __attribute__((address_space(3)))
typedef unsigned short bf16;
typedef unsigned v4u __attribute__((ext_vector_type(4)));
typedef float f32x4 __attribute__((ext_vector_type(4)));
typedef short bf16x8 __attribute__((ext_vector_type(8)));
typedef GAS unsigned gu32;
typedef GAS unsigned long long gu64;
#define RLX_AGENT __ATOMIC_RELAXED, __HIP_MEMORY_SCOPE_AGENT
#define LDS_WAIT() asm volatile("s_waitcnt lgkmcnt(0)" ::: "memory")
#define VM_WAIT() asm volatile("s_waitcnt vmcnt(0)" ::: "memory")
__device__ __forceinline__ unsigned long long rt() { return __builtin_amdgcn_s_memrealtime(); }
__device__ __forceinline__ unsigned f2bf(float f) { unsigned u = __builtin_bit_cast(unsigned, f); return (u + 0x7fffu + ((u >> 16) & 1u)) >> 16; }
__device__ __forceinline__ unsigned pk2(float lo, float hi) { return f2bf(lo) | (f2bf(hi) << 16); }

#define XB_TMO      128
#define XB_XCNT(j)  (256  + 64 * (j))
#define XB_XSUB(j)  (1280 + 64 * (j))
#define XB_XGEN(j)  (2304 + 64 * (j))
#define XB_TOP      3328
#define XB_TOPGEN   3392
#define XCD_BAR_WORDS 3456
#define XB_SPIN_CAP (1u << 18)

__device__ __forceinline__ unsigned xb_ld(unsigned* p)              { return __hip_atomic_load(p, __ATOMIC_RELAXED, __HIP_MEMORY_SCOPE_AGENT); }
__device__ __forceinline__ unsigned xb_add(unsigned* p, unsigned v) { return __hip_atomic_fetch_add(p, v, __ATOMIC_RELAXED, __HIP_MEMORY_SCOPE_AGENT); }
__device__ __forceinline__ unsigned xb_xcc_id() { return (unsigned)__builtin_amdgcn_s_getreg((3 << 11) | 20) & 0xFu; }
#define XB_SPIN(cond, bar) do { unsigned _sp = 0; while (cond) { __builtin_amdgcn_s_sleep(1); \
    if ((++_sp & 255u) == 0u) { if (xb_ld(&(bar)[XB_TMO])) break; if (_sp > XB_SPIN_CAP) { atomicAdd(&(bar)[XB_TMO], 1u); break; } } } } while (0)

struct XcdBarrier {
    unsigned* bar; unsigned x;
    volatile LAS unsigned* st;
};

__device__ __forceinline__ XcdBarrier xcd_barrier_post(unsigned* bar, volatile LAS unsigned* st) {
    XcdBarrier b; b.bar = bar; b.x = xb_xcc_id(); b.st = st;
    if (threadIdx.x == 0) (void)xb_add(&bar[XB_XCNT(b.x)], 1u);
    return b;
}
__device__ __forceinline__ void xcd_barrier_complete(unsigned* bar, unsigned x, unsigned& nloc, unsigned& nx) {
    const unsigned G = gridDim.x * gridDim.y * gridDim.z;
    unsigned sum, cnt, mine, sp = 0u;
    for (;;) {
        sum = 0u; cnt = 0u; mine = 0u;
#pragma unroll
        for (unsigned j = 0; j < 16; ++j) { const unsigned c = xb_ld(&bar[XB_XCNT(j)]); sum += c; cnt += (c > 0u) ? 1u : 0u; mine = (j == x) ? c : mine; }
        if (sum == G) break;
        __builtin_amdgcn_s_sleep(1);
        if ((++sp & 255u) == 0u) { if (xb_ld(&bar[XB_TMO])) break; if (sp > XB_SPIN_CAP) { atomicAdd(&bar[XB_TMO], 1u); break; } }
    }
    nloc = mine > 0u ? mine : 1u; nx = cnt > 0u ? cnt : 1u;
}

__device__ __forceinline__ void xcd_barrier(const XcdBarrier& b) {
    asm volatile("s_waitcnt vmcnt(0)" ::: "memory");
    __syncthreads();
    if (threadIdx.x == 0) {
        unsigned* bar = b.bar;
        __builtin_amdgcn_s_waitcnt(0);
        unsigned nloc = b.st[0], nx = b.st[1];
        if (nloc == 0u) { xcd_barrier_complete(bar, b.x, nloc, nx); b.st[0] = nloc; b.st[1] = nx; }
        const unsigned old = xb_add(&bar[XB_XSUB(b.x)], 1u);
        const unsigned gen = old / nloc;
        if (old + 1u == (gen + 1u) * nloc) {
            __builtin_amdgcn_fence(__ATOMIC_RELEASE, "agent");
            asm volatile("s_waitcnt vmcnt(0)" ::: "memory");
            const unsigned og = xb_add(&bar[XB_TOP], 1u);
            const unsigned tg = og / nx;
            if (og + 1u == (tg + 1u) * nx) xb_add(&bar[XB_TOPGEN], 1u);
            else XB_SPIN(xb_ld(&bar[XB_TOPGEN]) == tg, bar);
            __builtin_amdgcn_fence(__ATOMIC_ACQUIRE, "agent");
            xb_add(&bar[XB_XGEN(b.x)], 1u);
            asm volatile("s_waitcnt vmcnt(0)" ::: "memory");
        } else {
            XB_SPIN(xb_ld(&bar[XB_XGEN(b.x)]) == gen, bar);
            __builtin_amdgcn_fence(__ATOMIC_ACQUIRE, "agent");
            asm volatile("s_waitcnt vmcnt(0)" ::: "memory");
        }
    }
    __syncthreads();
}
typedef float f32x2 __attribute__((ext_vector_type(2)));
typedef unsigned u32x2 __attribute__((ext_vector_type(2)));
typedef unsigned short u16;
__device__ __forceinline__ float bf2f(unsigned u) { return __uint_as_float(u << 16); }
__device__ __forceinline__ float bflo(unsigned w) { return __uint_as_float(w << 16); }
__device__ __forceinline__ float bfhi(unsigned w) { return __uint_as_float(w & 0xffff0000u); }
__device__ __forceinline__ float ex2(float x) { return __builtin_amdgcn_exp2f(x); }
__device__ __forceinline__ float expf_(float x) { return __builtin_amdgcn_exp2f(x * 1.4426950408889634f); }
__device__ __forceinline__ float sigm(float x) { return __builtin_amdgcn_rcpf(1.f + expf_(-x)); }
__device__ __forceinline__ float tanhf_(float x) { return 1.f - 2.f * __builtin_amdgcn_rcpf(1.f + expf_(2.f * x)); }
__device__ __forceinline__ f32x4 mfma16(bf16x8 a, bf16x8 b, f32x4 c) { return __builtin_amdgcn_mfma_f32_16x16x32_bf16(a, b, c, 0, 0, 0); }
__device__ __forceinline__ bf16x8 mk8(unsigned a, unsigned b, unsigned c, unsigned d) { v4u t = {a, b, c, d}; return __builtin_bit_cast(bf16x8, t); }
template <int CTRL> __device__ __forceinline__ float dppf(float x) { return __uint_as_float((unsigned)__builtin_amdgcn_update_dpp(0, (int)__float_as_uint(x), CTRL, 0xf, 0xf, false)); }
template <int CTRL> __device__ __forceinline__ int dppi(int x) { return __builtin_amdgcn_update_dpp(0, x, CTRL, 0xf, 0xf, false); }
__device__ __forceinline__ float row_sum16(float x) { x += dppf<0xB1>(x); x += dppf<0x4E>(x); x += dppf<0x124>(x); x += dppf<0x128>(x); return x; }
__device__ __forceinline__ float row_max16(float x) { x = fmaxf(x, dppf<0xB1>(x)); x = fmaxf(x, dppf<0x4E>(x)); x = fmaxf(x, dppf<0x124>(x)); x = fmaxf(x, dppf<0x128>(x)); return x; }
__device__ __forceinline__ int row_max16i(int x) { x = max(x, dppi<0xB1>(x)); x = max(x, dppi<0x4E>(x)); x = max(x, dppi<0x124>(x)); x = max(x, dppi<0x128>(x)); return x; }
__device__ __forceinline__ float wave_sum(float v) {
#pragma unroll
    for (int o = 1; o < 64; o <<= 1) v += __shfl_xor(v, o);
    return v;
}
struct Frame {
    LAS unsigned char* lds;
    volatile LAS unsigned* MISC;
    gu32* ctl;
    int tid, lane, wave;
    int vcu, G;
    const float* in[27]; float* out; unsigned char* ws;
};
#define IN_X 0
#define IN_C 1
#define IN_ADAW 2
#define IN_ADAB 3
#define IN_N1W 4
#define IN_N2W 5
#define IN_WIN 6
#define IN_MU 7
#define IN_W0 8
#define IN_WUP 9
#define IN_A0 10
#define IN_AUP 11
#define IN_GUP 12
#define IN_KK 13
#define IN_KA 14
#define IN_RK 15
#define IN_LNW 16
#define IN_LNB 17
#define IN_QNW 18
#define IN_KNW 19
#define IN_SINK 20
#define IN_WOUT 21
#define IN_WQ 22
#define IN_KEY1 23
#define IN_KEY2 24
#define IN_PU 25
#define IN_PV 26

__device__ __forceinline__ void p0_transpose_item(const float* W, int K, int N, bf16* WT, int ldt, int koff, LAS float* scr, int item, int lane) {
    const int nblk = N / 32, kb = item / nblk, nb = item % nblk, k0 = 64 * kb, n0 = 32 * nb;
#pragma unroll 8
    for (int i = 0; i < 32; ++i) { const int kk = 2 * i + (lane >> 5); scr[kk * 33 + (lane & 31)] = W[(size_t)(k0 + kk) * N + n0 + (lane & 31)]; }
    LDS_WAIT(); asm volatile("" ::: "memory");
    const int c = lane & 7;
#pragma unroll
    for (int j = 0; j < 4; ++j) { const int n = (lane >> 3) + 8 * j; const LAS float* s = scr + (8 * c) * 33 + n;
        v4u o; o.x = pk2(s[0 * 33], s[1 * 33]); o.y = pk2(s[2 * 33], s[3 * 33]); o.z = pk2(s[4 * 33], s[5 * 33]); o.w = pk2(s[6 * 33], s[7 * 33]);
        *(GAS v4u*)(WT + (size_t)(n0 + n) * ldt + koff + k0 + 8 * c) = o; }
    LDS_WAIT(); asm volatile("" ::: "memory");
}
__device__ __forceinline__ void cvt_stream(const float* src, bf16* dst, size_t n8, size_t gt, size_t ngt) {
    for (size_t i = gt; i < n8; i += ngt) { const f32x4 a = *(const GAS f32x4*)(src + i * 8), b = *(const GAS f32x4*)(src + i * 8 + 4);
        v4u o; o.x = pk2(a.x, a.y); o.y = pk2(a.z, a.w); o.z = pk2(b.x, b.y); o.w = pk2(b.z, b.w); *(GAS v4u*)(dst + i * 8) = o; }
}
__device__ __forceinline__ void p0_prologue(Frame& F) {
    LAS float* scr = (LAS float*)(F.lds + F.wave * 16384);
    const int gw = F.vcu * NWAVES + F.wave, NGW = F.G * NWAVES;
    bf16* WTin = (bf16*)(F.ws + WS_WIN); bf16* WTout = (bf16*)(F.ws + WS_WOUT); bf16* WTq = (bf16*)(F.ws + WS_WQ);
    bf16* WTup = (bf16*)(F.ws + WS_WUP); bf16* WTaup = (bf16*)(F.ws + WS_AUP); bf16* WTgup = (bf16*)(F.ws + WS_GUP);
    constexpr int I_IN = (D / 64) * (INW / 32), I_OUT = (D / 64) * (D / 32), I_Q = (D / 64) * (2048 / 32), I_UP = 1 * (D / 32), I_GUP = 2 * (D / 32);
    constexpr int NITEMS = I_IN + 2 * I_OUT + I_Q + 2 * I_UP + I_GUP;
    for (int it = gw; it < NITEMS; it += NGW) {
        int r = it;
        if (r < I_IN) { p0_transpose_item(F.in[IN_WIN], D, INW, WTin, D, 0, scr, r, F.lane); continue; } r -= I_IN;
        if (r < I_OUT) { p0_transpose_item(F.in[IN_WOUT], D, D, WTout, 2048, 0, scr, r, F.lane); continue; } r -= I_OUT;
        if (r < I_OUT) { p0_transpose_item(F.in[IN_WOUT], D, D, WTout, 2048, 1024, scr, r, F.lane); continue; } r -= I_OUT;
        if (r < I_Q) { p0_transpose_item(F.in[IN_WQ], D, 2048, WTq, D, 0, scr, r, F.lane); continue; } r -= I_Q;
        if (r < I_UP) { p0_transpose_item(F.in[IN_WUP], 64, D, WTup, 64, 0, scr, r, F.lane); continue; } r -= I_UP;
        if (r < I_UP) { p0_transpose_item(F.in[IN_AUP], 64, D, WTaup, 64, 0, scr, r, F.lane); continue; } r -= I_UP;
        p0_transpose_item(F.in[IN_GUP], 128, D, WTgup, 128, 0, scr, r, F.lane);
    }
    const size_t gt = (size_t)F.vcu * 512 + F.tid, ngt = (size_t)F.G * 512;
    cvt_stream(F.in[IN_PU], (bf16*)(F.ws + WS_U), (size_t)NEXP * D / 8, gt, ngt);
    cvt_stream(F.in[IN_PV], (bf16*)(F.ws + WS_V), (size_t)NEXP * D / 8, gt, ngt);
    cvt_stream(F.in[IN_KEY1], (bf16*)(F.ws + WS_KEY1), 128 * 128 / 8, gt, ngt);
    cvt_stream(F.in[IN_KEY2], (bf16*)(F.ws + WS_KEY2), 128 * 128 / 8, gt, ngt);
    __syncthreads();
    LAS float* red = (LAS float*)F.lds;
    float* adap = (float*)(F.ws + WS_ADAP);
    for (int it = blockIdx.x; it < 24 * 16; it += F.G) {
        const int cb = it % 24, ks = it / 24, col = cb * 256 + (F.tid & 255), kh = F.tid >> 8, k0 = ks * 64 + kh * 32;
        float acc[8];
#pragma unroll
        for (int b = 0; b < 8; ++b) acc[b] = 0.f;
        const float* cw = F.in[IN_C];
        for (int k = 0; k < 32; ++k) { const float w = F.in[IN_ADAW][(size_t)(k0 + k) * NADA + col];
#pragma unroll
            for (int b = 0; b < 8; ++b) { const float cv = cw[b * D + k0 + k]; acc[b] += w * (cv * sigm(cv)); } }
        if (kh == 1) {
#pragma unroll
            for (int b = 0; b < 8; ++b) red[(F.tid & 255) * 8 + b] = acc[b]; }
        __syncthreads();
        if (kh == 0) {
#pragma unroll
            for (int b = 0; b < 8; ++b) adap[((size_t)ks * 8 + b) * NADA + col] = acc[b] + red[(F.tid & 255) * 8 + b]; }
        __syncthreads();
    }
}
__device__ __forceinline__ void p1_ada(Frame& F) {
    const float* adap = (const float*)(F.ws + WS_ADAP); float* ada = (float*)(F.ws + WS_ADA);
    for (int i = F.vcu * 512 + F.tid; i < 8 * NADA; i += F.G * 512) { const int col = i % NADA; float s = F.in[IN_ADAB][col];
#pragma unroll
        for (int ks = 0; ks < 16; ++ks) s += adap[(size_t)ks * 8 * NADA + i];
        ada[i] = s; }
}
__device__ __forceinline__ void norm_rows(Frame& F, const float* src, bf16* dst, const float* nw, int sh_off, int sc_off) {
    const float* ada = (const float*)(F.ws + WS_ADA);
    const int gw = F.vcu * NWAVES + F.wave, NGW = F.G * NWAVES;
    for (int r0 = gw * 32; r0 < M; r0 += NGW * 32) {
        const int b = r0 / SEQ; f32x4 g[4], s[4];
#pragma unroll
        for (int j = 0; j < 4; ++j) { const int c = 4 * F.lane + 256 * j; const f32x4 w = *(const GAS f32x4*)(nw + c), sc = *(const GAS f32x4*)(ada + b * NADA + sc_off + c);
            g[j] = w * (sc + 1.0f); s[j] = *(const GAS f32x4*)(ada + b * NADA + sh_off + c); }
        for (int r = r0; r < r0 + 32; ++r) {
            const GAS f32x4* xr = (const GAS f32x4*)(src + (size_t)r * D) + F.lane; f32x4 v[4]; float ss = 0.f;
#pragma unroll
            for (int j = 0; j < 4; ++j) { v[j] = xr[64 * j]; ss += (v[j].x * v[j].x + v[j].y * v[j].y) + (v[j].z * v[j].z + v[j].w * v[j].w); }
            const float rstd = 1.f / sqrtf(wave_sum(ss) * (1.f / D) + 1e-6f);
            GAS unsigned long long* o8 = (GAS unsigned long long*)(dst + (size_t)r * D) + F.lane;
#pragma unroll
            for (int j = 0; j < 4; ++j) { const f32x4 y = v[j] * rstd * g[j] + s[j];
                o8[64 * j] = (unsigned long long)pk2(y.x, y.y) | ((unsigned long long)pk2(y.z, y.w) << 32); }
        }
    }
}
__device__ __forceinline__ void p4_act(Frame& F) {
    const bf16* P = (const bf16*)(F.ws + WS_P); bf16* ACT = (bf16*)(F.ws + WS_ACT); const float* mu = F.in[IN_MU];
    for (size_t i = (size_t)F.vcu * 512 + F.tid; i < (size_t)M * 256; i += (size_t)F.G * 512) {
        const int m = (int)(i >> 8), j = (int)(i & 255), t = m & (SEQ - 1), col = C_PW + j;
        const float cur = bf2f(P[(size_t)m * INW + col]), prev = t ? bf2f(P[(size_t)(m - 1) * INW + col]) : 0.f;
        const float v = cur + (prev - cur) * mu[col];
        const float o = j < 64 ? tanhf_(v) : (j < 128 ? v : sigm(v));
        ACT[i] = (bf16)f2bf(o);
    }
}
constexpr int RW_PKG = 15168, RW_AT = 0, RW_RT = 2048, RW_BKT = 4096, RW_VT = 9216, RW_FT = 11776, RW_FNAK = 12800, RW_FM = 13824, RW_GAM = 14848, RW_BON = 15104;
constexpr int RW_SCR0 = 8 * RW_PKG, RW_SCR = 4608;
static_assert(RW_SCR0 + 8 * RW_SCR <= RING_BYTES, "rwkv LDS");
__device__ __forceinline__ int rw_pos(int k) { return 32 * (k >> 5) + 8 * ((k >> 2) & 3) + 4 * ((k >> 4) & 1) + (k & 3); }
__device__ __forceinline__ bf16x8 frag_lo(const f32x4 d) { return mk8(pk2(d.x, d.y), pk2(d.z, d.w), 0u, 0u); }

__device__ __forceinline__ void rwkv_unit(Frame& F, int b, int h) {
    const bf16* P = (const bf16*)(F.ws + WS_P); const bf16* ACT = (const bf16*)(F.ws + WS_ACT);
    const bf16* WTup = (const bf16*)(F.ws + WS_WUP); const bf16* WTaup = (const bf16*)(F.ws + WS_AUP); const bf16* WTgup = (const bf16*)(F.ws + WS_GUP);
    bf16* YAB = (bf16*)F.out;
    const int lane = F.lane, w = F.wave, c = lane & 15, q = lane >> 4;
    LAS unsigned char* lds = F.lds;
    f32x4 Z[4];
#pragma unroll
    for (int m = 0; m < 4; ++m) Z[m] = (f32x4){0.f, 0.f, 0.f, 0.f};
    const size_t rowb = (size_t)b * SEQ;
    for (int grp = 0; grp < SEQ / 128; ++grp) {
        unsigned opq = 0u; asm volatile("" : "+v"(opq));
        {
            const int tok0 = grp * 128 + w * 16; const size_t row0 = rowb + tok0;
            const bf16* Pg = P + row0 * INW; const bf16* ACTg = ACT + row0 * 256;
            const unsigned hc = (unsigned)(h * 64 + c) + opq;
            LAS unsigned char* pk = lds + w * RW_PKG; LAS unsigned char* sc = lds + RW_SCR0 + w * RW_SCR;
            bf16x8 aw[2], aa[2];
#pragma unroll
            for (int s = 0; s < 2; ++s) { aw[s] = *(const GAS bf16x8*)(ACTg + (unsigned)(c * 256 + 32 * s + 8 * q)); aa[s] = *(const GAS bf16x8*)(ACTg + (unsigned)(c * 256 + 64 + 32 * s + 8 * q)); }
            float r_[4][4], k_[4][4];
            float ld[4][4], eta[4][4], kr[4][4];
            float ss[4], bon[4];
            const bool first = (tok0 == 0) && (q == 0);
#pragma unroll
            for (int i = 0; i < 4; ++i) { ss[i] = 0.f; bon[i] = 0.f; }
#pragma unroll
            for (int n = 0; n < 4; ++n) {
                const unsigned col = hc + 16u * n;
                f32x4 lw = {0.f, 0.f, 0.f, 0.f}, la = {0.f, 0.f, 0.f, 0.f};
#pragma unroll
                for (int s = 0; s < 2; ++s) {
                    const bf16x8 bw = *(const GAS bf16x8*)(WTup + (col * 64u + 32u * s + 8u * q));
                    const bf16x8 ba = *(const GAS bf16x8*)(WTaup + (col * 64u + 32u * s + 8u * q));
                    lw = mfma16(aw[s], bw, lw); la = mfma16(aa[s], ba, la); }
                const float cw0 = F.in[IN_W0][col], ca0 = F.in[IN_A0][col], ckk = F.in[IN_KK][col], cka = F.in[IN_KA][col], crk = F.in[IN_RK][col];
                const float cmur = F.in[IN_MU][C_PR + col], cmuk = F.in[IN_MU][C_PK + col], cmuv = F.in[IN_MU][C_PV + col];
                const unsigned po = 4u * q * INW + col;
                float pr = 0.f, pkv = 0.f, pv = 0.f;
                if (!first) { const bf16* Pm = Pg - INW; pr = bf2f(Pm[po + C_PR]); pkv = bf2f(Pm[po + C_PK]); pv = bf2f(Pm[po + C_PV]); }
                float vsh[4];
#pragma unroll
                for (int i = 0; i < 4; ++i) {
                    const float cr = bf2f(Pg[po + (unsigned)(i * INW + C_PR)]), ck = bf2f(Pg[po + (unsigned)(i * INW + C_PK)]), cv = bf2f(Pg[po + (unsigned)(i * INW + C_PV)]);
                    r_[n][i] = cr + (pr - cr) * cmur; const float ksh = ck + (pkv - ck) * cmuk; vsh[i] = cv + (pv - cv) * cmuv;
                    pr = cr; pkv = ck; pv = cv;
                    ld[n][i] = -0.6065306597126334f * sigm(cw0 + lw[i]);
                    eta[n][i] = sigm(ca0 + la[i]);
                    kr[n][i] = ksh * ckk; ss[i] += kr[n][i] * kr[n][i];
                    k_[n][i] = ksh * (1.f + (eta[n][i] - 1.f) * cka);
                    bon[i] += r_[n][i] * k_[n][i] * crk; }
                u32x2 vv; vv.x = pk2(vsh[0], vsh[1]); vv.y = pk2(vsh[2], vsh[3]);
                *(LAS u32x2*)(pk + RW_VT + (16 * n + c) * 40 + 8 * q) = vv;
                __builtin_amdgcn_sched_barrier(0);
            }
            float rn[4];
#pragma unroll
            for (int i = 0; i < 4; ++i) { ss[i] = row_sum16(ss[i]); bon[i] = row_sum16(bon[i]); rn[i] = 1.f / fmaxf(sqrtf(ss[i]), 1e-12f); }
            if (c == 0) *(LAS f32x4*)(pk + RW_BON + 16 * q) = (f32x4){bon[0], bon[1], bon[2], bon[3]};
#pragma unroll
            for (int n = 0; n < 4; ++n) {
                const float c0 = ld[n][0], c1 = c0 + ld[n][1], c2 = c1 + ld[n][2], c3 = c2 + ld[n][3];
                float t1 = __shfl_up(c3, 16); if (q < 1) t1 = 0.f; const float s1 = c3 + t1;
                float t2 = __shfl_up(s1, 32); if (q < 2) t2 = 0.f; const float s2 = s1 + t2;
                const float ex = s2 - c3;
                const float cum[4] = {ex + c0, ex + c1, ex + c2, ex + c3};
                if (q == 3) *(LAS float*)(pk + RW_GAM + 4 * (16 * n + c)) = expf_(s2);
                const int kcol = 16 * n + c, ps = rw_pos(kcol);
                unsigned short bt[4], kt[4];
#pragma unroll
                for (int i = 0; i < 4; ++i) {
                    const float gam = expf_(cum[i]), igam = expf_(-cum[i]), gprev = expf_(cum[i] - ld[n][i]);
                    const float kap = kr[n][i] * rn[i];
                    const float At = -kap * gprev, Bt = kap * eta[n][i] * igam, Kt = k_[n][i] * igam, Rt = r_[n][i] * gam;
                    const int tr = 4 * q + i;
                    *(LAS unsigned short*)(pk + RW_AT + tr * 128 + 2 * ps) = (unsigned short)f2bf(At);
                    *(LAS unsigned short*)(pk + RW_RT + tr * 128 + 2 * ps) = (unsigned short)f2bf(Rt);
                    bt[i] = (unsigned short)f2bf(Bt); kt[i] = (unsigned short)f2bf(Kt);
                    *(LAS unsigned short*)(sc + tr * 128 + 2 * ps) = bt[i];
                    *(LAS unsigned short*)(sc + 2048 + tr * 128 + 2 * ps) = kt[i]; }
                v4u bk; bk.x = bt[0] | ((unsigned)bt[1] << 16); bk.y = bt[2] | ((unsigned)bt[3] << 16); bk.z = kt[0] | ((unsigned)kt[1] << 16); bk.w = kt[2] | ((unsigned)kt[3] << 16);
                *(LAS v4u*)(pk + RW_BKT + kcol * 80 + 16 * q) = bk;
            }
            LDS_WAIT(); asm volatile("" ::: "memory");
            bf16x8 fA[2], fB[2], fK[2], fR[2];
#pragma unroll
            for (int s = 0; s < 2; ++s) {
                fA[s] = *(const LAS bf16x8*)(pk + RW_AT + c * 128 + 64 * s + 16 * q); fR[s] = *(const LAS bf16x8*)(pk + RW_RT + c * 128 + 64 * s + 16 * q);
                fB[s] = *(const LAS bf16x8*)(sc + c * 128 + 64 * s + 16 * q);         fK[s] = *(const LAS bf16x8*)(sc + 2048 + c * 128 + 64 * s + 16 * q); }
            const f32x4 z4 = {0.f, 0.f, 0.f, 0.f};
            f32x4 dN = mfma16(fA[1], fB[1], mfma16(fA[0], fB[0], z4));
            f32x4 dNt = mfma16(fB[1], fA[1], mfma16(fB[0], fA[0], z4));
            f32x4 dNAKt = mfma16(fK[1], fA[1], mfma16(fK[0], fA[0], z4));
            f32x4 dMRBt = mfma16(fB[1], fR[1], mfma16(fB[0], fR[0], z4));
            f32x4 dMRKt = mfma16(fK[1], fR[1], mfma16(fK[0], fR[0], z4));
            f32x4 eye;
#pragma unroll
            for (int i = 0; i < 4; ++i) { const int row = 4 * q + i;
                dN[i] = (c < row) ? dN[i] : 0.f;
                dNt[i] = (row < c) ? dNt[i] : 0.f;
                dNAKt[i] = (row < c) ? dNAKt[i] : 0.f;
                dMRBt[i] = (row <= c) ? dMRBt[i] : 0.f;
                dMRKt[i] = (row <= c) ? dMRKt[i] : 0.f;
                eye[i] = (row == c) ? 1.f : 0.f; }
            const bf16x8 gN = frag_lo(dN), gNt = frag_lo(dNt);
            const f32x4 dN2 = mfma16(gNt, gN, z4), dN2t = mfma16(gN, gNt, z4);
            const bf16x8 gN2 = frag_lo(dN2), gN2t = frag_lo(dN2t);
            const f32x4 dN4 = mfma16(gN2t, gN2, z4), dN4t = mfma16(gN2, gN2t, z4);
            const f32x4 dN3t = mfma16(gN2, gNt, z4);
            const bf16x8 gN4 = frag_lo(dN4), gN4t = frag_lo(dN4t);
            const f32x4 dN8 = mfma16(gN4t, gN4, z4);
            const bf16x8 gN8 = frag_lo(dN8);
            const f32x4 dN12 = mfma16(gN4t, gN8, z4);
            const f32x4 dP1t = eye + dNt + dN2t + dN3t, dP2 = eye + dN4 + dN8 + dN12;
            const f32x4 dTt = mfma16(frag_lo(dP2), frag_lo(dP1t), z4);
            *(LAS v4u*)(pk + RW_FT + 16 * lane) = (v4u){pk2(dTt.x, dTt.y), pk2(dTt.z, dTt.w), 0u, 0u};
            *(LAS v4u*)(pk + RW_FNAK + 16 * lane) = (v4u){0u, 0u, pk2(dNAKt.x, dNAKt.y), pk2(dNAKt.z, dNAKt.w)};
            *(LAS v4u*)(pk + RW_FM + 16 * lane) = (v4u){pk2(dMRBt.x, dMRBt.y), pk2(dMRBt.z, dMRBt.w), pk2(dMRKt.x, dMRKt.y), pk2(dMRKt.z, dMRKt.w)};
        }
        LDS_WAIT(); __syncthreads();
        if (w < 4) {
            const int vs = w;
#pragma unroll 1
            for (int ch = 0; ch < 8; ++ch) {
                LAS unsigned char* pk = lds + ch * RW_PKG; LAS float* ysc = (LAS float*)(lds + RW_SCR0 + ch * RW_SCR);
                bf16x8 zb[2];
#pragma unroll
                for (int s = 0; s < 2; ++s) zb[s] = mk8(pk2(Z[2 * s].x, Z[2 * s].y), pk2(Z[2 * s].z, Z[2 * s].w), pk2(Z[2 * s + 1].x, Z[2 * s + 1].y), pk2(Z[2 * s + 1].z, Z[2 * s + 1].w));
                const bf16x8 aA0 = *(const LAS bf16x8*)(pk + RW_AT + c * 128 + 16 * q), aA1 = *(const LAS bf16x8*)(pk + RW_AT + c * 128 + 64 + 16 * q);
                const bf16x8 aR0 = *(const LAS bf16x8*)(pk + RW_RT + c * 128 + 16 * q), aR1 = *(const LAS bf16x8*)(pk + RW_RT + c * 128 + 64 + 16 * q);
                const u32x2 vt = *(const LAS u32x2*)(pk + RW_VT + (16 * vs + c) * 40 + 8 * q);
                const bf16x8 fT = *(const LAS bf16x8*)(pk + RW_FT + 16 * lane), fNAK = *(const LAS bf16x8*)(pk + RW_FNAK + 16 * lane), fM = *(const LAS bf16x8*)(pk + RW_FM + 16 * lane);
                const f32x4 z4 = {0.f, 0.f, 0.f, 0.f};
                const bf16x8 bV = mk8(0u, 0u, vt.x, vt.y);
                f32x4 X = mfma16(aA0, zb[0], z4); X = mfma16(aA1, zb[1], X); X = mfma16(fNAK, bV, X);
                const f32x4 U = mfma16(fT, mk8(pk2(X.x, X.y), pk2(X.z, X.w), 0u, 0u), z4);
                const bf16x8 bUV = mk8(pk2(U.x, U.y), pk2(U.z, U.w), vt.x, vt.y);
                f32x4 Y = mfma16(aR0, zb[0], z4); Y = mfma16(aR1, zb[1], Y); Y = mfma16(fM, bUV, Y);
#pragma unroll
                for (int i = 0; i < 4; ++i) ysc[(4 * q + i) * 64 + 16 * vs + c] = Y[i];
#pragma unroll
                for (int m = 0; m < 4; ++m) {
                    const bf16x8 aBK = *(const LAS bf16x8*)(pk + RW_BKT + (16 * m + c) * 80 + 16 * q);
                    const f32x4 gm = *(const LAS f32x4*)(pk + RW_GAM + 4 * (16 * m + 4 * q));
                    Z[m] = mfma16(aBK, bUV, Z[m]) * gm; }
            }
        }
        LDS_WAIT(); __syncthreads();
        {
            const int tok0 = grp * 128 + w * 16; const size_t row0 = rowb + tok0;
            const bf16* Pg = P + row0 * INW; const bf16* ACTg = ACT + row0 * 256; bf16* Yg = YAB + row0 * 2048;
            const unsigned hc = (unsigned)(h * 64 + c) + opq;
            LAS unsigned char* pk = lds + w * RW_PKG; const LAS float* ysc = (const LAS float*)(lds + RW_SCR0 + w * RW_SCR);
            f32x4 g[4];
#pragma unroll
            for (int n = 0; n < 4; ++n) g[n] = (f32x4){0.f, 0.f, 0.f, 0.f};
#pragma unroll
            for (int s = 0; s < 4; ++s) {
                const bf16x8 ag = *(const GAS bf16x8*)(ACTg + (unsigned)(c * 256 + 128 + 32 * s + 8 * q));
#pragma unroll
                for (int n = 0; n < 4; ++n) { const bf16x8 bg = *(const GAS bf16x8*)(WTgup + ((hc + 16u * n) * 128u + 32u * s + 8u * q)); g[n] = mfma16(ag, bg, g[n]); }
            }
            float y[4][4], mu[4], var[4];
#pragma unroll
            for (int i = 0; i < 4; ++i) { mu[i] = 0.f; var[i] = 0.f; }
#pragma unroll
            for (int n = 0; n < 4; ++n)
#pragma unroll
                for (int i = 0; i < 4; ++i) { y[n][i] = ysc[(4 * q + i) * 64 + 16 * n + c]; mu[i] += y[n][i]; }
#pragma unroll
            for (int i = 0; i < 4; ++i) mu[i] = row_sum16(mu[i]) * (1.f / 64.f);
#pragma unroll
            for (int n = 0; n < 4; ++n)
#pragma unroll
                for (int i = 0; i < 4; ++i) { const float d = y[n][i] - mu[i]; var[i] += d * d; }
            const f32x4 bonv = *(const LAS f32x4*)(pk + RW_BON + 16 * q);
#pragma unroll
            for (int i = 0; i < 4; ++i) var[i] = 1.f / sqrtf(row_sum16(var[i]) * (1.f / 64.f) + 64e-5f);
#pragma unroll
            for (int n = 0; n < 4; ++n) {
                const unsigned col = hc + 16u * n; const float lw_ = F.in[IN_LNW][col], lb_ = F.in[IN_LNB][col];
                const u32x2 vt = *(const LAS u32x2*)(pk + RW_VT + (16 * n + c) * 40 + 8 * q);
                const float vv[4] = {bflo(vt.x), bfhi(vt.x), bflo(vt.y), bfhi(vt.y)};
#pragma unroll
                for (int i = 0; i < 4; ++i) {
                    const unsigned rl = 4u * q + i;
                    const float ga = bf2f(Pg[rl * INW + C_GA + col]);
                    const float o = ((y[n][i] - mu[i]) * var[i] * lw_ + lb_ + bonv[i] * vv[i]) * g[n][i] * sigm(ga);
                    Yg[rl * 2048u + col] = (bf16)f2bf(o); }
            }
        }
    }
}
constexpr int AT_KROW = 144, AT_VROW = 528, AT_K = 0, AT_V = 256 * AT_KROW  , AT_END = AT_V + 64 * AT_VROW;
static_assert(AT_END <= RING_BYTES, "attn LDS");
__device__ __forceinline__ int at_pos(int key) { return 32 * (key >> 5) + 8 * ((key >> 2) & 3) + 4 * ((key >> 4) & 1) + (key & 3); }
__device__ __forceinline__ void attn_unit(Frame& F, int b, int g, int blk) {
    const bf16* P = (const bf16*)(F.ws + WS_P); bf16* YAB = (bf16*)F.out;
    const int lane = F.lane, n = F.wave, c = lane & 15, q = lane >> 4, tid = F.tid;
    LAS unsigned char* lds = F.lds;
    const size_t rowb = (size_t)b * SEQ;
    __syncthreads();
    {
        const int kj = tid >> 1, hf = tid & 1, pos = blk * 128 - 128 + kj;
        float kv[32], vv[32];
        if (pos >= 0) {
            const bf16* kp = P + (rowb + pos) * INW + C_AK + g * 64 + hf * 32; const bf16* vp = P + (rowb + pos) * INW + C_AV + g * 64 + hf * 32;
#pragma unroll
            for (int j = 0; j < 4; ++j) { const v4u a = *(const GAS v4u*)(kp + 8 * j), e = *(const GAS v4u*)(vp + 8 * j);
                kv[8 * j + 0] = bflo(a.x); kv[8 * j + 1] = bfhi(a.x); kv[8 * j + 2] = bflo(a.y); kv[8 * j + 3] = bfhi(a.y); kv[8 * j + 4] = bflo(a.z); kv[8 * j + 5] = bfhi(a.z); kv[8 * j + 6] = bflo(a.w); kv[8 * j + 7] = bfhi(a.w);
                vv[8 * j + 0] = bflo(e.x); vv[8 * j + 1] = bfhi(e.x); vv[8 * j + 2] = bflo(e.y); vv[8 * j + 3] = bfhi(e.y); vv[8 * j + 4] = bflo(e.z); vv[8 * j + 5] = bfhi(e.z); vv[8 * j + 6] = bflo(e.w); vv[8 * j + 7] = bfhi(e.w); }
        } else {
#pragma unroll
            for (int j = 0; j < 32; ++j) { kv[j] = 0.f; vv[j] = 0.f; }
        }
        float ss = 0.f;
#pragma unroll
        for (int j = 0; j < 32; ++j) ss += kv[j] * kv[j];
        ss += __shfl_xor(ss, 1);
        const float rstd = 1.f / sqrtf(ss * (1.f / 64.f) + 1e-6f);
#pragma unroll
        for (int j = 0; j < 4; ++j) { v4u o;
            const float* kw = F.in[IN_KNW] + hf * 32 + 8 * j;
            o.x = pk2(kv[8 * j] * rstd * kw[0], kv[8 * j + 1] * rstd * kw[1]); o.y = pk2(kv[8 * j + 2] * rstd * kw[2], kv[8 * j + 3] * rstd * kw[3]);
            o.z = pk2(kv[8 * j + 4] * rstd * kw[4], kv[8 * j + 5] * rstd * kw[5]); o.w = pk2(kv[8 * j + 6] * rstd * kw[6], kv[8 * j + 7] * rstd * kw[7]);
            *(LAS v4u*)(lds + AT_K + kj * AT_KROW + hf * 64 + 16 * j) = o; }
        const int ps = at_pos(kj);
#pragma unroll
        for (int j = 0; j < 32; ++j) *(LAS unsigned short*)(lds + AT_V + (hf * 32 + j) * AT_VROW + 2 * ps) = (unsigned short)f2bf(vv[j]);
    }
    LDS_WAIT(); __syncthreads();
    const int hq = g * 8 + n;
    const float sink2 = F.in[IN_SINK][hq] * 1.4426950408889634f;
    const float qsc = 0.125f * 1.4426950408889634f;
#pragma unroll 1
    for (int qt = 0; qt < 8; ++qt) {
        const size_t qrow = rowb + blk * 128 + 16 * qt + c;
        bf16x8 qf[2];
        {
            const bf16* qp = P + qrow * INW + C_AQ + hq * 64 + 8 * q;
            const v4u a0 = *(const GAS v4u*)(qp), a1 = *(const GAS v4u*)(qp + 32);
            float x0[8] = {bflo(a0.x), bfhi(a0.x), bflo(a0.y), bfhi(a0.y), bflo(a0.z), bfhi(a0.z), bflo(a0.w), bfhi(a0.w)};
            float x1[8] = {bflo(a1.x), bfhi(a1.x), bflo(a1.y), bfhi(a1.y), bflo(a1.z), bfhi(a1.z), bflo(a1.w), bfhi(a1.w)};
            float ss = 0.f;
#pragma unroll
            for (int j = 0; j < 8; ++j) ss += x0[j] * x0[j] + x1[j] * x1[j];
            ss += __shfl_xor(ss, 16); ss += __shfl_xor(ss, 32);
            const float rs = qsc / sqrtf(ss * (1.f / 64.f) + 1e-6f);
            const float* qw0 = F.in[IN_QNW] + 8 * q; const float* qw1 = qw0 + 32;
            qf[0] = mk8(pk2(x0[0] * rs * qw0[0], x0[1] * rs * qw0[1]), pk2(x0[2] * rs * qw0[2], x0[3] * rs * qw0[3]), pk2(x0[4] * rs * qw0[4], x0[5] * rs * qw0[5]), pk2(x0[6] * rs * qw0[6], x0[7] * rs * qw0[7]));
            qf[1] = mk8(pk2(x1[0] * rs * qw1[0], x1[1] * rs * qw1[1]), pk2(x1[2] * rs * qw1[2], x1[3] * rs * qw1[3]), pk2(x1[4] * rs * qw1[4], x1[5] * rs * qw1[5]), pk2(x1[6] * rs * qw1[6], x1[7] * rs * qw1[7]));
        }
        const int sp0 = qt >> 1;
        f32x4 st[10];
        float mx = sink2;
#pragma unroll
        for (int tl = 0; tl < 10; ++tl) {
            const int kt = 2 * sp0 + tl;
            const bf16x8 k0 = *(const LAS bf16x8*)(lds + AT_K + (16 * kt + c) * AT_KROW + 16 * q), k1 = *(const LAS bf16x8*)(lds + AT_K + (16 * kt + c) * AT_KROW + 64 + 16 * q);
            f32x4 s = mfma16(k0, qf[0], (f32x4){0.f, 0.f, 0.f, 0.f}); s = mfma16(k1, qf[1], s);
#pragma unroll
            for (int i = 0; i < 4; ++i) { const int kj = 16 * kt + 4 * q + i, rel = kj - (16 * qt + c);
                const bool ok = (rel >= 1) && (rel <= 128) && (blk * 128 - 128 + kj >= 0);
                s[i] = ok ? s[i] : -1e30f; mx = fmaxf(mx, s[i]); }
            st[tl] = s;
        }
        mx = fmaxf(mx, __shfl_xor(mx, 16)); mx = fmaxf(mx, __shfl_xor(mx, 32));
        float den = 0.f;
#pragma unroll
        for (int tl = 0; tl < 10; ++tl)
#pragma unroll
            for (int i = 0; i < 4; ++i) { const float p = ex2(st[tl][i] - mx); st[tl][i] = p; den += p; }
        den += __shfl_xor(den, 16); den += __shfl_xor(den, 32);
        den += ex2(sink2 - mx);
        const float rden = 1.f / den;
        f32x4 o[4];
#pragma unroll
        for (int m = 0; m < 4; ++m) o[m] = (f32x4){0.f, 0.f, 0.f, 0.f};
#pragma unroll
        for (int sl = 0; sl < 5; ++sl) {
            const bf16x8 pf = mk8(pk2(st[2 * sl].x, st[2 * sl].y), pk2(st[2 * sl].z, st[2 * sl].w), pk2(st[2 * sl + 1].x, st[2 * sl + 1].y), pk2(st[2 * sl + 1].z, st[2 * sl + 1].w));
#pragma unroll
            for (int m = 0; m < 4; ++m) { const bf16x8 vf = *(const LAS bf16x8*)(lds + AT_V + (16 * m + c) * AT_VROW + 64 * (sp0 + sl) + 16 * q); o[m] = mfma16(vf, pf, o[m]); }
        }
#pragma unroll
        for (int m = 0; m < 4; ++m) { const int col = hq * 64 + 16 * m + 4 * q;
            const u32x2 gb = *(const GAS u32x2*)(P + qrow * INW + C_GB + col);
            u32x2 w2; w2.x = pk2(o[m].x * rden * sigm(bflo(gb.x)), o[m].y * rden * sigm(bfhi(gb.x))); w2.y = pk2(o[m].z * rden * sigm(bflo(gb.y)), o[m].w * rden * sigm(bfhi(gb.y)));
            *(GAS u32x2*)(YAB + qrow * 2048 + 1024 + col) = w2; }
    }
}
typedef __bf16 bf16x2_t __attribute__((ext_vector_type(2)));
__device__ __forceinline__ float dot2bf(unsigned a, unsigned b, float c) { return __builtin_amdgcn_fdot2_f32_bf16(__builtin_bit_cast(bf16x2_t, a), __builtin_bit_cast(bf16x2_t, b), c, false); }
template <int NV> __device__ __forceinline__ void row_top16(float (&val)[NV], const int (&id)[NV], int c, float& tv, int& ti) {
    tv = -3.0e38f; ti = 0;
#pragma unroll 1
    for (int it = 0; it < 16; ++it) {
        float lm = val[0];
#pragma unroll
        for (int j = 1; j < NV; ++j) lm = fmaxf(lm, val[j]);
        const float rm = row_max16(lm);
        int li = -1;
#pragma unroll
        for (int j = 0; j < NV; ++j) { const bool hit = (val[j] == rm); li = hit ? max(li, id[j]) : li; val[j] = hit ? -3.0e38f : val[j]; }
        const int ri = row_max16i(li);
        if (c == it) { tv = rm; ti = ri; }
    }
}
__device__ __forceinline__ void peer_route(Frame& F) {
    const bf16* Q = (const bf16*)(F.ws + WS_Q); const bf16* K1 = (const bf16*)(F.ws + WS_KEY1); const bf16* K2 = (const bf16*)(F.ws + WS_KEY2);
    int* IDX = (int*)(F.ws + WS_IDX); float* GATE = (float*)(F.ws + WS_GATE);
    const int lane = F.lane, c = lane & 15, q = lane >> 4;
    const int gw = F.vcu * NWAVES + F.wave, NGW = F.G * NWAVES;
    for (int tile = gw; tile < M / 16; tile += NGW) {
        const size_t r0 = (size_t)tile * 16;
#pragma unroll 1
        for (int hh = 0; hh < 8; ++hh) {
            float tv[2][4]; int ti[2][4];
#pragma unroll
            for (int hf = 0; hf < 2; ++hf) {
                const bf16* KT = hf ? K2 : K1;
                f32x4 S[8];
#pragma unroll
                for (int nt = 0; nt < 8; ++nt) S[nt] = (f32x4){0.f, 0.f, 0.f, 0.f};
#pragma unroll
                for (int s = 0; s < 4; ++s) {
                    const bf16x8 a = *(const GAS bf16x8*)(Q + (r0 + c) * 2048 + hh * 256 + hf * 128 + 32 * s + 8 * q);
#pragma unroll
                    for (int nt = 0; nt < 8; ++nt) { const bf16x8 bk = *(const GAS bf16x8*)(KT + (16 * nt + c) * 128 + 32 * s + 8 * q); S[nt] = mfma16(a, bk, S[nt]); }
                }
#pragma unroll
                for (int i = 0; i < 4; ++i) {
                    float val[8]; int id[8];
#pragma unroll
                    for (int nt = 0; nt < 8; ++nt) { val[nt] = S[nt][i]; id[nt] = 16 * nt + c; }
                    row_top16<8>(val, id, c, tv[hf][i], ti[hf][i]);
                }
            }
#pragma unroll
            for (int i = 0; i < 4; ++i) {
                float cv[16]; int cid[16];
                const float v1 = tv[0][i]; const int i1 = ti[0][i] * 128; const float v2 = tv[1][i]; const int i2 = ti[1][i];
                cv[0] = v1 + v2; cid[0] = i1 + i2;
#define ROT(n) cv[n] = v1 + dppf<0x120 + n>(v2); cid[n] = i1 + dppi<0x120 + n>(i2);
                ROT(1) ROT(2) ROT(3) ROT(4) ROT(5) ROT(6) ROT(7) ROT(8) ROT(9) ROT(10) ROT(11) ROT(12) ROT(13) ROT(14) ROT(15)
#undef ROT
                float sv; int si;
                row_top16<16>(cv, cid, c, sv, si);
                const float mx = row_max16(sv);
                const float e = expf_(sv - mx);
                const float gsum = row_sum16(e);
                const size_t t = r0 + 4 * q + i;
                IDX[t * 128 + hh * 16 + c] = si; GATE[t * 128 + hh * 16 + c] = e / gsum;
            }
        }
    }
}
__device__ __forceinline__ float gelu_exact(float x) { return 0.5f * x * (1.f + erff(x * 0.70710678118654752f)); }
__device__ __forceinline__ void peer_experts(Frame& F) {
    const bf16* H2 = (const bf16*)(F.ws + WS_H2); const bf16* U = (const bf16*)(F.ws + WS_U); const bf16* V = (const bf16*)(F.ws + WS_V);
    const int* IDX = (const int*)(F.ws + WS_IDX); const float* GATE = (const float*)(F.ws + WS_GATE);
    const float* X1 = (const float*)(F.ws + WS_X1); const float* ada = (const float*)(F.ws + WS_ADA);
    const int lane = F.lane, sub = lane & 15, rg = lane >> 4;
    LAS float* wbuf = (LAS float*)(F.lds + F.wave * 1024); LAS int* ibuf = (LAS int*)(F.lds + F.wave * 1024 + 512);
    const int gw = F.vcu * NWAVES + F.wave, NGW = F.G * NWAVES;
    for (int t = gw; t < M; t += NGW) {
        const int b = t / SEQ;
        v4u hc[8];
#pragma unroll
        for (int i = 0; i < 8; ++i) hc[i] = *(const GAS v4u*)(H2 + (size_t)t * D + (i * 16 + sub) * 8);
        const int idA = IDX[(size_t)t * 128 + lane], idB = IDX[(size_t)t * 128 + 64 + lane];
        const float gA = GATE[(size_t)t * 128 + lane], gB = GATE[(size_t)t * 128 + 64 + lane];
        ibuf[lane] = idA; ibuf[64 + lane] = idB;
#pragma unroll 4
        for (int eg = 0; eg < 32; ++eg) {
            const int j = 4 * eg + rg;
            const int e = __shfl(eg < 16 ? idA : idB, j & 63);
            const float gt = __shfl(eg < 16 ? gA : gB, j & 63);
            const bf16* ur = U + (size_t)e * D + sub * 8;
            float acc = 0.f;
#pragma unroll
            for (int i = 0; i < 8; ++i) { const v4u uv = *(const GAS v4u*)(ur + i * 128);
                acc = dot2bf(uv.x, hc[i].x, acc); acc = dot2bf(uv.y, hc[i].y, acc); acc = dot2bf(uv.z, hc[i].z, acc); acc = dot2bf(uv.w, hc[i].w, acc); }
            acc = row_sum16(acc);
            if (sub == 0) wbuf[j] = gt * gelu_exact(acc);
        }
        LDS_WAIT(); asm volatile("" ::: "memory");
        float o[16];
#pragma unroll
        for (int i = 0; i < 16; ++i) o[i] = 0.f;
#pragma unroll 4
        for (int j = 0; j < 128; ++j) {
            const int e = ibuf[j]; const float wv = wbuf[j];
            const bf16* vr = V + (size_t)e * D + lane * 8;
            const v4u x0 = *(const GAS v4u*)(vr), x1 = *(const GAS v4u*)(vr + 512);
            o[0] += wv * bflo(x0.x); o[1] += wv * bfhi(x0.x); o[2] += wv * bflo(x0.y); o[3] += wv * bfhi(x0.y); o[4] += wv * bflo(x0.z); o[5] += wv * bfhi(x0.z); o[6] += wv * bflo(x0.w); o[7] += wv * bfhi(x0.w);
            o[8] += wv * bflo(x1.x); o[9] += wv * bfhi(x1.x); o[10] += wv * bflo(x1.y); o[11] += wv * bfhi(x1.y); o[12] += wv * bflo(x1.z); o[13] += wv * bfhi(x1.z); o[14] += wv * bflo(x1.w); o[15] += wv * bfhi(x1.w);
        }
        const float* gt2 = ada + b * NADA + 5120;
#pragma unroll
        for (int hh = 0; hh < 2; ++hh) { const int col = hh * 512 + lane * 8;
#pragma unroll
            for (int k4 = 0; k4 < 2; ++k4) { const f32x4 xv = *(const GAS f32x4*)(X1 + (size_t)t * D + col + 4 * k4), gv = *(const GAS f32x4*)(gt2 + col + 4 * k4);
                f32x4 ov; ov.x = xv.x + gv.x * o[hh * 8 + 4 * k4]; ov.y = xv.y + gv.y * o[hh * 8 + 4 * k4 + 1]; ov.z = xv.z + gv.z * o[hh * 8 + 4 * k4 + 2]; ov.w = xv.w + gv.w * o[hh * 8 + 4 * k4 + 3];
                *(GAS f32x4*)(F.out + (size_t)t * D + col + 4 * k4) = ov; } }
        LDS_WAIT(); asm volatile("" ::: "memory");
    }
}
struct Args { const float* in[27]; float* out; unsigned char* ws; int ph_lo, ph_hi, li, pad; };
__global__ void __launch_bounds__(NWAVES * 64, 2) fwd_kernel(Args args) {
    extern __shared__ __attribute__((aligned(16))) unsigned char lds[];
    Frame F;
    F.lds = (LAS unsigned char*)lds;
    F.MISC = (volatile LAS unsigned*)(F.lds + MISC_OFF);
    F.tid = threadIdx.x; F.lane = F.tid & 63; F.wave = __builtin_amdgcn_readfirstlane(F.tid >> 6);
    F.G = gridDim.x; { const int bx = blockIdx.x; F.vcu = (F.G % 8 == 0) ? (bx % 8) * (F.G / 8) + bx / 8 : bx; }
    F.ws = args.ws; F.out = args.out; F.ctl = (gu32*)(args.ws + WS_CTL);
#pragma unroll
    for (int i = 0; i < 27; ++i) F.in[i] = args.in[i];
    for (int u = F.tid; u < (LDS_BYTES - LDSCTL_OFF) / 4; u += NWAVES * 64) ((LAS unsigned*)(F.lds + LDSCTL_OFF))[u] = 0u;
    __syncthreads();
    constexpr bool ONE = (MK_N_LAUNCHES == 1);
    XcdBarrier bar; bar.bar = (unsigned*)(F.ctl + CW_BAR); bar.x = 0; bar.st = nullptr;
    if (ONE) bar = xcd_barrier_post((unsigned*)(F.ctl + CW_BAR), F.MISC + 8);
#define GRID_BAR() do { if (ONE) xcd_barrier(bar); } while (0)
    const int lo = args.ph_lo, hi = args.ph_hi;
#ifndef PH_MASK
#define PH_MASK 0x7ff
#endif
#define IN(k) (((PH_MASK >> (k)) & 1) && lo <= (k) && (k) < hi)
#define BOTH(k) (IN(k) && IN((k) + 1))
    if (IN(0)) { p0_prologue(F); if (BOTH(0)) GRID_BAR(); }
    if (IN(1)) { p1_ada(F); if (BOTH(1)) GRID_BAR(); }
    if (IN(2)) { norm_rows(F, F.in[IN_X], (bf16*)F.out, F.in[IN_N1W], 0, 1024); if (BOTH(2)) GRID_BAR(); }
    if (IN(3)) {
        pg8::Gemm g{(const pg8::bf16_t*)F.out, (const pg8::bf16_t*)(F.ws + WS_WIN), M, INW, D}; pg8::StaticOrder S; S.init(M, INW, F.G, (int)blockIdx.x);
        pg8::EpiBf16<0> E{(pg8::bf16_t*)(F.ws + WS_P), INW, nullptr, 0, 0, 1.f};
        pg8::gemm_phase<pg8::EpiBf16<0>, pg8::StaticOrder, PG8_ALIGN, PG8_SP2>(F.lds, g, S, E);
        if (BOTH(3)) GRID_BAR();
    }
    if (IN(4)) { p4_act(F); if (BOTH(4)) GRID_BAR(); }
    if (IN(5)) {
        const int half = F.G / 2;
        if ((int)blockIdx.x < half) {
#ifndef NO_RWKV
            for (int u = blockIdx.x; u < BATCH * 16; u += half) rwkv_unit(F, u >> 4, u & 15);
#endif
        }
        else {
#ifndef NO_ATTN
            for (int u = blockIdx.x - half; u < BATCH * 2 * 64; u += F.G - half) attn_unit(F, u >> 7, (u >> 6) & 1, u & 63);
#endif
        }
        if (BOTH(5)) GRID_BAR();
    }
    if (IN(6)) {
        pg8::Gemm g{(const pg8::bf16_t*)F.out, (const pg8::bf16_t*)(F.ws + WS_WOUT), M, D, 2048}; pg8::StaticOrder S; S.init(M, D, F.G, (int)blockIdx.x);
        pg8::EpiResid E{F.in[IN_X], (float*)(F.ws + WS_X1), (const float*)(F.ws + WS_ADA) + 2048};
        pg8::gemm_phase<pg8::EpiResid, pg8::StaticOrder, PG8_ALIGN, PG8_SP2>(F.lds, g, S, E);
        if (BOTH(6)) GRID_BAR();
    }
    if (IN(7)) { norm_rows(F, (const float*)(F.ws + WS_X1), (bf16*)(F.ws + WS_H2), F.in[IN_N2W], 3072, 4096); if (BOTH(7)) GRID_BAR(); }
    if (IN(8)) {
        pg8::Gemm g{(const pg8::bf16_t*)(F.ws + WS_H2), (const pg8::bf16_t*)(F.ws + WS_WQ), M, 2048, D}; pg8::StaticOrder S; S.init(M, 2048, F.G, (int)blockIdx.x);
        pg8::EpiBf16<0> E{(pg8::bf16_t*)(F.ws + WS_Q), 2048, nullptr, 0, 0, 1.f};
        pg8::gemm_phase<pg8::EpiBf16<0>, pg8::StaticOrder, PG8_ALIGN, PG8_SP2>(F.lds, g, S, E);
        if (BOTH(8)) GRID_BAR();
    }
    if (IN(9)) { peer_route(F); if (BOTH(9)) GRID_BAR(); }
    if (IN(10)) { peer_experts(F); }
#undef IN
#undef BOTH
}

extern "C" void kernel_launch(void* const* d_in, const int* in_sizes, int n_in, void* d_out, int out_size, void* d_ws, size_t ws_size, hipStream_t stream) {
    static int grid = 0;
    if (grid == 0) {
        if (n_in != 27 || in_sizes[0] != M * D || out_size != M * D || ws_size < WS_END) { fprintf(stderr, "kernel_launch: unexpected shapes n_in %d in0 %d out %d ws %zu (need %zu)\n", n_in, n_in > 0 ? in_sizes[0] : -1, out_size, ws_size, (size_t)WS_END); grid = -1; return; }
        int dev = 0, cus = 0, per_cu = 0;
        if (hipGetDevice(&dev) != hipSuccess || hipDeviceGetAttribute(&cus, hipDeviceAttributeMultiprocessorCount, dev) != hipSuccess) { fprintf(stderr, "kernel_launch: device query failed\n"); grid = -1; return; }
        if (hipFuncSetAttribute((const void*)fwd_kernel, hipFuncAttributeMaxDynamicSharedMemorySize, LDS_BYTES) != hipSuccess) { fprintf(stderr, "kernel_launch: hipFuncSetAttribute failed\n"); grid = -1; return; }
        if (hipOccupancyMaxActiveBlocksPerMultiprocessor(&per_cu, (const void*)fwd_kernel, NWAVES * 64, LDS_BYTES) != hipSuccess || per_cu < 1) fprintf(stderr, "kernel_launch: occupancy query says %d\n", per_cu);
        (void)hipGetLastError();
        grid = cus;
    }
    if (grid < 0) return;
    if (hipMemsetAsync((char*)d_ws + WS_CTL, 0, CTL_ZERO_BYTES, stream) != hipSuccess) { fprintf(stderr, "kernel_launch: memset failed\n"); return; }
    Args a{};
    for (int i = 0; i < 27; ++i) a.in[i] = (const float*)d_in[i];
    a.out = (float*)d_out; a.ws = (unsigned char*)d_ws;
    if (MK_N_LAUNCHES == 1) {
        a.ph_lo = 0; a.ph_hi = NPHASE; a.li = 0;
        hipLaunchKernelGGL(fwd_kernel, dim3(grid), dim3(NWAVES * 64), LDS_BYTES, stream, a);
    } else {
        for (int li = 0; li < NPHASE; ++li) { a.ph_lo = li; a.ph_hi = li + 1; a.li = li;
            hipLaunchKernelGGL(fwd_kernel, dim3(grid), dim3(NWAVES * 64), LDS_BYTES, stream, a);
            const hipError_t le = hipPeekAtLastError(); if (le != hipSuccess) { fprintf(stderr, "kernel_launch: launch %d failed: %s\n", li, hipGetErrorName(le)); break; } }
    }
}
```
